# Optimizing an MI355X kernel written in HIP

```python
import math
import jax
import jax.numpy as jnp
from jax import lax
import numpy as np

D_MODEL = 1024
BATCH = 8
SEQ = 2048
DEPTH = 2

CHUNK = 64

D_A = D_MODEL // 2
S5_H = 16
S5_G = D_A // S5_H
S5_P = 64
DT_MIN = 1e-3
DT_MAX = 1e-1
D_B = D_MODEL - D_A
POOL_WINDOWS = (2, 4, 8, 16)
POOL_GROUPS = len(POOL_WINDOWS)
POOL_C = D_B // POOL_GROUPS
SB_HEADS = 16
SB_HEAD_DIM = D_MODEL // SB_HEADS
SB_BLOCK = 128
N_EXPERTS = 16
N_EXPERT_GROUPS = 4
EXPERTS_PER_GROUP = N_EXPERTS // N_EXPERT_GROUPS
TOP_K = 2
D_EXPERT = 512
PLE_DIM = 256
DEEPNORM_ALPHA = (2 * DEPTH) ** 0.25
DEEPNORM_BETA = (8 * DEPTH) ** -0.25
LN_EPS = 1e-5
N_EVEN = (DEPTH + 1) // 2
N_ODD = DEPTH // 2

kernel_name = 'hybrid_s5_pool_stickbreak_moe_trunk'

F32 = jnp.float32


def layer_norm(x, g, b):
    x32 = x.astype(F32)
    mu = jnp.mean(x32, axis=-1, keepdims=True)
    var = jnp.mean(jnp.square(x32 - mu), axis=-1, keepdims=True)
    return ((x32 - mu) * lax.rsqrt(var + LN_EPS) * g.astype(F32) + b.astype(F32)).astype(x.dtype)


def _complex_linear_combine(e1, e2):
    a1r, a1i, b1r, b1i = e1
    a2r, a2i, b2r, b2i = e2
    ar = a2r * a1r - a2i * a1i
    ai = a2r * a1i + a2i * a1r
    br = a2r * b1r - a2i * b1i + b2r
    bi = a2r * b1i + a2i * b1r + b2i
    return (ar, ai, br, bi)


def s5_mixer(u, lam_re, lam_im, log_dt, b_re, b_im, c_re, c_im, d_skip, w_glu):
    bsz, s, _ = u.shape
    u32 = u.astype(F32).reshape(bsz, s, S5_G, S5_H)
    lam_re = lam_re.astype(F32)
    lam_im = lam_im.astype(F32)
    dt = jnp.exp(log_dt.astype(F32))[:, None]
    mag = jnp.exp(lam_re * dt)
    ang = lam_im * dt
    lb_re = mag * jnp.cos(ang)
    lb_im = mag * jnp.sin(ang)
    den = lam_re * lam_re + lam_im * lam_im
    num_re = lb_re - 1.0
    f_re = (num_re * lam_re + lb_im * lam_im) / den
    f_im = (lb_im * lam_re - num_re * lam_im) / den
    b_re = b_re.astype(F32)
    b_im = b_im.astype(F32)
    bb_re = f_re[..., None] * b_re - f_im[..., None] * b_im
    bb_im = f_re[..., None] * b_im + f_im[..., None] * b_re
    bu_re = jnp.einsum('bsgh,gph->sbgp', u32, bb_re)
    bu_im = jnp.einsum('bsgh,gph->sbgp', u32, bb_im)
    a_re = jnp.broadcast_to(lb_re[None, None], (s, 1, S5_G, S5_P))
    a_im = jnp.broadcast_to(lb_im[None, None], (s, 1, S5_G, S5_P))
    _, _, st_re, st_im = lax.associative_scan(
        _complex_linear_combine, (a_re, a_im, bu_re, bu_im), axis=0)
    y = (jnp.einsum('sbgp,ghp->bsgh', st_re, c_re.astype(F32))
         - jnp.einsum('sbgp,ghp->bsgh', st_im, c_im.astype(F32))
         + d_skip.astype(F32) * u32)
    y = jax.nn.gelu(y.reshape(bsz, s, D_A))
    out = y * jax.nn.sigmoid(y @ w_glu.astype(F32))
    return out.astype(u.dtype)


def pool_mixer(v, pool_w, pool_scale):
    bsz, s, _ = v.shape
    v32 = v.astype(F32).reshape(bsz, s, POOL_GROUPS, POOL_C)
    csum = jnp.cumsum(v32, axis=1)
    t = jnp.arange(s)
    means = []
    for gi, w in enumerate(POOL_WINDOWS):
        c = csum[:, :, gi]
        lagged = jnp.pad(c, ((0, 0), (w, 0), (0, 0)))[:, :s]
        count = jnp.minimum(t + 1, w).astype(F32)[None, :, None]
        means.append((c - lagged) / count)
    pooled = jnp.stack(means, axis=2) - v32
    mixed = jnp.einsum('bsgc,gcd->bsgd', pooled, pool_w.astype(F32))
    return (mixed.reshape(bsz, s, D_B) * pool_scale.astype(F32)).astype(v.dtype)


def stick_breaking_attention(qkv):
    bsz, s, _ = qkv.shape
    q, k, v = jnp.split(qkv.astype(F32), 3, axis=-1)
    to_heads = lambda z: z.reshape(bsz, s, SB_HEADS, SB_HEAD_DIM).transpose(0, 2, 1, 3)
    q, k, v = to_heads(q), to_heads(k), to_heads(v)
    scale = SB_HEAD_DIM ** -0.5
    outs = []
    for blk in range(s // SB_BLOCK):
        q0 = blk * SB_BLOCK
        end = q0 + SB_BLOCK
        z = jnp.einsum('bhqd,bhkd->bhqk', q[:, :, q0:end], k[:, :, :end]) * scale
        t_pos = q0 + jnp.arange(SB_BLOCK)
        s_pos = jnp.arange(end)
        causal = s_pos[None, :] < t_pos[:, None]
        log_keep = jnp.where(causal, jax.nn.log_sigmoid(-z), 0.0)
        log_after = lax.cumsum(log_keep, axis=3, reverse=True) - log_keep
        wts = jnp.where(causal, jnp.exp(jax.nn.log_sigmoid(z) + log_after), 0.0)
        outs.append(jnp.einsum('bhqk,bhkd->bhqd', wts, v[:, :, :end]))
    o = jnp.concatenate(outs, axis=2)
    return o.transpose(0, 2, 1, 3).reshape(bsz, s, D_MODEL).astype(qkv.dtype)


def grouped_moe(x, router_w, router_bias, w1, w3, w2):
    bsz, s, d = x.shape
    xt = x.reshape(-1, d)
    scores = jax.nn.sigmoid((xt @ router_w).astype(F32))
    sel = scores + router_bias.astype(F32)
    grp = sel.reshape(-1, N_EXPERT_GROUPS, EXPERTS_PER_GROUP)
    grp_score = jnp.sum(lax.top_k(grp, TOP_K)[0], axis=-1)
    top_group = jnp.argmax(grp_score, axis=-1)
    in_group = (jnp.arange(N_EXPERTS) // EXPERTS_PER_GROUP)[None, :] == top_group[:, None]
    _, idx = lax.top_k(jnp.where(in_group, sel, -jnp.inf), TOP_K)
    w = jnp.take_along_axis(scores, idx, axis=-1)
    w = w / jnp.sum(w, axis=-1, keepdims=True)
    gates = jnp.sum(jax.nn.one_hot(idx, N_EXPERTS, dtype=F32) * w[..., None], axis=1)
    h = jax.nn.silu(jnp.einsum('td,edf->etf', xt, w1)) * jnp.einsum('td,edf->etf', xt, w3)
    h = h * gates.T[:, :, None].astype(h.dtype)
    y = jnp.einsum('etf,efd->td', h, w2)
    return y.reshape(bsz, s, d).astype(x.dtype)


def setup_inputs(seed: int = 0) -> dict:
    key = jax.random.key(seed)
    ks = jax.random.split(key, 32)
    nrm = lambda k, shape, sc: jax.random.normal(k, shape, F32) * sc
    n_idx = jnp.arange(S5_P, dtype=F32)
    return {
        'x': nrm(ks[0], (BATCH, SEQ, D_MODEL), 1.0),
        'p': nrm(ks[1], (DEPTH, BATCH, SEQ, PLE_DIM), 1.0),
        'ab_w_in': nrm(ks[2], (N_EVEN, D_MODEL, D_A + D_B), D_MODEL ** -0.5),
        's5_lambda_re': -0.5 + nrm(ks[3], (N_EVEN, S5_G, S5_P), 0.01),
        's5_lambda_im': math.pi * n_idx + nrm(ks[4], (N_EVEN, S5_G, S5_P), 0.01),
        's5_log_dt': jax.random.uniform(ks[5], (N_EVEN, S5_G), F32, math.log(DT_MIN), math.log(DT_MAX)),
        's5_b_re': nrm(ks[6], (N_EVEN, S5_G, S5_P, S5_H), (2 * S5_H) ** -0.5),
        's5_b_im': nrm(ks[7], (N_EVEN, S5_G, S5_P, S5_H), (2 * S5_H) ** -0.5),
        's5_c_re': nrm(ks[8], (N_EVEN, S5_G, S5_H, S5_P), S5_P ** -0.5),
        's5_c_im': nrm(ks[9], (N_EVEN, S5_G, S5_H, S5_P), S5_P ** -0.5),
        's5_d': nrm(ks[10], (N_EVEN, S5_G, S5_H), 1.0),
        's5_w_glu': nrm(ks[11], (N_EVEN, D_A, D_A), D_A ** -0.5),
        'pool_w': nrm(ks[12], (N_EVEN, POOL_GROUPS, POOL_C, POOL_C), POOL_C ** -0.5),
        'pool_scale': 1.0 + nrm(ks[13], (N_EVEN, D_B), 0.1),
        'ab_w_out': nrm(ks[14], (N_EVEN, D_A + D_B, D_MODEL), (D_A + D_B) ** -0.5 * DEEPNORM_BETA),
        'sb_w_qkv': nrm(ks[15], (N_ODD, D_MODEL, 3 * D_MODEL), D_MODEL ** -0.5),
        'sb_w_out': nrm(ks[16], (N_ODD, D_MODEL, D_MODEL), D_MODEL ** -0.5 * DEEPNORM_BETA),
        'ln_mix_g': 1.0 + nrm(ks[17], (DEPTH, D_MODEL), 0.01),
        'ln_mix_b': nrm(ks[18], (DEPTH, D_MODEL), 0.01),
        'ln_ffn_g': 1.0 + nrm(ks[19], (DEPTH, D_MODEL), 0.01),
        'ln_ffn_b': nrm(ks[20], (DEPTH, D_MODEL), 0.01),
        'router_w': nrm(ks[21], (D_MODEL, N_EXPERTS), D_MODEL ** -0.5),
        'router_bias': nrm(ks[22], (N_EXPERTS,), 0.01),
        'moe_w1': nrm(ks[23], (DEPTH, N_EXPERTS, D_MODEL, D_EXPERT), D_MODEL ** -0.5),
        'moe_w3': nrm(ks[24], (DEPTH, N_EXPERTS, D_MODEL, D_EXPERT), D_MODEL ** -0.5),
        'moe_w2': nrm(ks[25], (DEPTH, N_EXPERTS, D_EXPERT, D_MODEL), D_EXPERT ** -0.5 * DEEPNORM_BETA),
        'ple_w_proj': nrm(ks[26], (DEPTH, PLE_DIM, D_MODEL), PLE_DIM ** -0.5 * DEEPNORM_BETA),
        'ple_w_gate': nrm(ks[27], (DEPTH, D_MODEL, D_MODEL), D_MODEL ** -0.5),
    }


def reference(x, p, ab_w_in, s5_lambda_re, s5_lambda_im, s5_log_dt, s5_b_re, s5_b_im,
              s5_c_re, s5_c_im, s5_d, s5_w_glu, pool_w, pool_scale, ab_w_out,
              sb_w_qkv, sb_w_out, ln_mix_g, ln_mix_b, ln_ffn_g, ln_ffn_b,
              router_w, router_bias, moe_w1, moe_w3, moe_w2, ple_w_proj, ple_w_gate):
    for i in range(DEPTH):
        j = i // 2
        if i % 2 == 0:
            h = x @ ab_w_in[j]
            out_a = s5_mixer(h[..., :D_A], s5_lambda_re[j], s5_lambda_im[j], s5_log_dt[j],
                             s5_b_re[j], s5_b_im[j], s5_c_re[j], s5_c_im[j], s5_d[j], s5_w_glu[j])
            out_b = pool_mixer(h[..., D_A:], pool_w[j], pool_scale[j])
            mix = jnp.concatenate([out_a, out_b], axis=-1) @ ab_w_out[j]
        else:
            mix = stick_breaking_attention(x @ sb_w_qkv[j]) @ sb_w_out[j]
        x = layer_norm(DEEPNORM_ALPHA * x + mix, ln_mix_g[i], ln_mix_b[i])
        ple = (p[i] @ ple_w_proj[i]) * jax.nn.sigmoid(x @ ple_w_gate[i])
        ffn = grouped_moe(x, router_w, router_bias, moe_w1[i], moe_w3[i], moe_w2[i])
        x = layer_norm(DEEPNORM_ALPHA * x + ffn + ple, ln_ffn_g[i], ln_ffn_b[i])
    return x
```

```cpp
#include <hip/hip_runtime.h>
#include <cstdio>
#include <cstdint>

namespace nv {
constexpr int D = 1024, BATCH = 8, SEQ = 2048, T = BATCH * SEQ;
constexpr int DA = 512, S5H = 16, S5G = 32, S5P = 64, DB = 512, PG = 4, PC = 128;
constexpr int NH = 16, HD = 64, NE = 16, DEXP = 512, PLE = 256;
constexpr float ALPHA = 1.41421356237309515f;
constexpr float LN_EPS = 1e-5f;
constexpr int CAP = T;

struct GArgs {
    const float* A; const int* amap; const float* B; float* C; const int* cmap; const int* Mptr; const float* aux; const float* vec; const float* rs;
    long sA, sB, sC, sAux;
    int lda, ashift, ldb, ldc, cshift, M, N, K, sMap, ldaux, sVec, epi;
};
static_assert(sizeof(GArgs) == 9 * 8 + 4 * 8 + 12 * 4, "GArgs has padding");

__device__ __forceinline__ float sigmoidf_(float x) { return 1.f / (1.f + __expf(-x)); }

__global__ void __launch_bounds__(256) gemm_naive(GArgs g) {
    __shared__ float As[16][65];
    __shared__ float Bs[16][65];
    const int z = blockIdx.z;
    const int M = g.Mptr ? g.Mptr[z] : g.M;
    const int m0 = blockIdx.y * 64, n0 = blockIdx.x * 64;
    if (m0 >= M) return;
    const float* A = g.A + (long)z * g.sA; const float* B = g.B + (long)z * g.sB; float* C = g.C + (long)z * g.sC;
    const int* amap = g.amap ? g.amap + (long)z * g.sMap : nullptr;
    const int* cmap = g.cmap ? g.cmap + (long)z * g.sMap : nullptr;
    const int tid = threadIdx.x, tx = tid & 15, ty = tid >> 4;
    float acc[4][4];
#pragma unroll
    for (int i = 0; i < 4; ++i)
#pragma unroll
        for (int j = 0; j < 4; ++j) acc[i][j] = 0.f;
    const int ar = tid >> 2, ak = (tid & 3) * 4;
    const int arow = m0 + ar; const bool aval = arow < M;
    const long asrc = aval ? (amap ? (long)(amap[arow] >> g.ashift) : (long)arow) : 0;
    const int bk = tid >> 4, bn = (tid & 15) * 4;
    for (int k0 = 0; k0 < g.K; k0 += 16) {
        float4 av = make_float4(0.f, 0.f, 0.f, 0.f);
        if (aval) av = *(const float4*)(A + asrc * g.lda + k0 + ak);
        const float4 bv = *(const float4*)(B + (long)(k0 + bk) * g.ldb + n0 + bn);
        As[ak + 0][ar] = av.x; As[ak + 1][ar] = av.y; As[ak + 2][ar] = av.z; As[ak + 3][ar] = av.w;
        Bs[bk][bn + 0] = bv.x; Bs[bk][bn + 1] = bv.y; Bs[bk][bn + 2] = bv.z; Bs[bk][bn + 3] = bv.w;
        __syncthreads();
#pragma unroll
        for (int kk = 0; kk < 16; ++kk) {
            float a[4], b[4];
#pragma unroll
            for (int i = 0; i < 4; ++i) a[i] = As[kk][ty * 4 + i];
#pragma unroll
            for (int j = 0; j < 4; ++j) b[j] = Bs[kk][tx * 4 + j];
#pragma unroll
            for (int i = 0; i < 4; ++i)
#pragma unroll
                for (int j = 0; j < 4; ++j) acc[i][j] = fmaf(a[i], b[j], acc[i][j]);
        }
        __syncthreads();
    }
    const float* aux = g.aux ? g.aux + (long)z * g.sAux : nullptr;
#pragma unroll
    for (int i = 0; i < 4; ++i) {
        const int row = m0 + ty * 4 + i;
        if (row < M) {
            const long crow = cmap ? (long)(cmap[row] >> g.cshift) : (long)row;
#pragma unroll
            for (int j = 0; j < 4; ++j) {
                const int col = n0 + tx * 4 + j;
                float v = acc[i][j];
                if (g.epi == 1) v = aux[crow * g.ldaux + col] * sigmoidf_(v);
                else if (g.epi == 2) v = v * g.vec[z * g.sVec + col];
                else if (g.epi == 4) { const float a1 = aux[crow * g.ldaux + col]; v = a1 * sigmoidf_(a1) * v * g.rs[crow]; }
                if (g.epi == 5) atomicAdd(C + crow * g.ldc + col, v);
                else C[crow * g.ldc + col] = v;
            }
        }
    }
}

__global__ void __launch_bounds__(64) s5_naive(const float* h, const float* lam_re, const float* lam_im, const float* log_dt, const float* b_re, const float* b_im,
                                               const float* c_re, const float* c_im, const float* dsk, float* ybuf) {
    __shared__ float st_re[64][65], st_im[64][65];
    __shared__ float cre[16][64], cim[16][64];
    __shared__ float us[64][16];
    const int b = blockIdx.x / S5G, g = blockIdx.x % S5G, p = threadIdx.x;
    const float dt = expf(log_dt[g]);
    const float lr = lam_re[g * S5P + p], li = lam_im[g * S5P + p];
    const float mag = expf(lr * dt), ang = li * dt;
    const float lbr = mag * cosf(ang), lbi = mag * sinf(ang);
    const float den = lr * lr + li * li, nr = lbr - 1.f;
    const float fr = (nr * lr + lbi * li) / den, fi = (lbi * lr - nr * li) / den;
    float bbr[16], bbi[16];
#pragma unroll
    for (int k = 0; k < 16; ++k) { const float br = b_re[(g * S5P + p) * S5H + k], bi = b_im[(g * S5P + p) * S5H + k]; bbr[k] = fr * br - fi * bi; bbi[k] = fr * bi + fi * br; }
    for (int i = p; i < 16 * 64; i += 64) { cre[i / 64][i % 64] = c_re[g * S5H * S5P + i]; cim[i / 64][i % 64] = c_im[g * S5H * S5P + i]; }
    float dreg[16];
#pragma unroll
    for (int k = 0; k < 16; ++k) dreg[k] = dsk[g * S5H + k];
    float hr = 0.f, hi = 0.f;
    __syncthreads();
    for (int c0 = 0; c0 < SEQ; c0 += 64) {
        for (int i = p; i < 64 * 16; i += 64) us[i / 16][i % 16] = h[(long)(b * SEQ + c0 + i / 16) * D + g * S5H + (i % 16)];
        __syncthreads();
        for (int t = 0; t < 64; ++t) {
            float ur = 0.f, ui = 0.f;
#pragma unroll
            for (int k = 0; k < 16; ++k) { const float u = us[t][k]; ur = fmaf(bbr[k], u, ur); ui = fmaf(bbi[k], u, ui); }
            const float nhr = lbr * hr - lbi * hi + ur, nhi = lbr * hi + lbi * hr + ui;
            hr = nhr; hi = nhi;
            st_re[t][p] = hr; st_im[t][p] = hi;
        }
        __syncthreads();
        {
            float y[16];
#pragma unroll
            for (int k = 0; k < 16; ++k) y[k] = dreg[k] * us[p][k];
            for (int q = 0; q < 64; ++q) {
                const float sr = st_re[p][q], si = st_im[p][q];
#pragma unroll
                for (int k = 0; k < 16; ++k) y[k] = fmaf(sr, cre[k][q], fmaf(-si, cim[k][q], y[k]));
            }
#pragma unroll
            for (int k = 0; k < 16; ++k) {
                const float v = y[k];
                const float gl = 0.5f * v * (1.f + tanhf(0.7978845608028654f * (v + 0.044715f * v * v * v)));
                ybuf[(long)(b * SEQ + c0 + p) * DA + g * S5H + k] = gl;
            }
        }
        __syncthreads();
    }
}

__global__ void pool_naive(const float* h, float* pooled) {
    const long i = (long)blockIdx.x * blockDim.x + threadIdx.x;
    if (i >= (long)T * DB) return;
    const int c = (int)(i % DB); const long row = i / DB; const int t = (int)(row % SEQ);
    const int w = 2 << (c / PC);
    const int n = (t + 1 < w) ? t + 1 : w;
    float s = 0.f;
    for (int k = 0; k < n; ++k) s += h[(row - k) * D + DA + c];
    pooled[i] = s / (float)n - h[row * D + DA + c];
}

__global__ void __launch_bounds__(256) ln_naive(const float* a, const float* b, const float* c, const float* gam, const float* bet, float* out) {
    const int row = blockIdx.x * 4 + (threadIdx.x >> 6), lane = threadIdx.x & 63;
    if (row >= T) return;
    float v[16]; float s = 0.f;
#pragma unroll
    for (int j = 0; j < 16; ++j) { const int col = lane + 64 * j; float x = ALPHA * a[(long)row * D + col] + b[(long)row * D + col]; if (c) x += c[(long)row * D + col]; v[j] = x; s += x; }
#pragma unroll
    for (int o = 1; o < 64; o <<= 1) s += __shfl_xor(s, o);
    const float mean = s * (1.f / D); float q = 0.f;
#pragma unroll
    for (int j = 0; j < 16; ++j) { const float d = v[j] - mean; q += d * d; }
#pragma unroll
    for (int o = 1; o < 64; o <<= 1) q += __shfl_xor(q, o);
    const float rstd = rsqrtf(q * (1.f / D) + LN_EPS);
#pragma unroll
    for (int j = 0; j < 16; ++j) { const int col = lane + 64 * j; out[(long)row * D + col] = (v[j] - mean) * rstd * gam[col] + bet[col]; }
}

__global__ void __launch_bounds__(256) route_naive(const float* x, const float* rw, const float* rb, int* cnt, int* lists, float* entw) {
    const int tok = blockIdx.x * 4 + (threadIdx.x >> 6), lane = threadIdx.x & 63;
    if (tok >= T) return;
    float acc[16];
#pragma unroll
    for (int e = 0; e < 16; ++e) acc[e] = 0.f;
    for (int j = 0; j < 16; ++j) {
        const int k = lane + 64 * j; const float xv = x[(long)tok * D + k];
#pragma unroll
        for (int e = 0; e < 16; ++e) acc[e] = fmaf(xv, rw[k * NE + e], acc[e]);
    }
#pragma unroll
    for (int e = 0; e < 16; ++e) {
#pragma unroll
        for (int o = 1; o < 64; o <<= 1) acc[e] += __shfl_xor(acc[e], o);
    }
    if (lane == 0) {
        float sc[16], sel[16];
#pragma unroll
        for (int e = 0; e < 16; ++e) { sc[e] = 1.f / (1.f + expf(-acc[e])); sel[e] = sc[e] + rb[e]; }
        int bg = 0; float bgs = -INFINITY;
#pragma unroll
        for (int gi = 0; gi < 4; ++gi) {
            float m1 = -INFINITY, m2 = -INFINITY;
#pragma unroll
            for (int j = 0; j < 4; ++j) { const float v = sel[gi * 4 + j]; if (v > m1) { m2 = m1; m1 = v; } else if (v > m2) m2 = v; }
            const float gs = m1 + m2;
            if (gs > bgs) { bgs = gs; bg = gi; }
        }
        int i1 = 0, i2 = 0; float v1 = -INFINITY, v2 = -INFINITY;
#pragma unroll
        for (int gi = 0; gi < 4; ++gi)
#pragma unroll
            for (int j = 0; j < 4; ++j) {
                if (gi == bg) { const float v = sel[gi * 4 + j]; const int e = gi * 4 + j;
                    if (v > v1) { v2 = v1; i2 = i1; v1 = v; i1 = e; } else if (v > v2) { v2 = v; i2 = e; } }
            }
        float w1 = 0.f, w2 = 0.f;
#pragma unroll
        for (int e = 0; e < 16; ++e) { if (e == i1) w1 = sc[e]; if (e == i2) w2 = sc[e]; }
        const float inv = 1.f / (w1 + w2);
        entw[2 * tok] = w1 * inv; entw[2 * tok + 1] = w2 * inv;
        const int p1 = atomicAdd(cnt + i1, 1); lists[i1 * CAP + p1] = 2 * tok;
        const int p2 = atomicAdd(cnt + i2, 1); lists[i2 * CAP + p2] = 2 * tok + 1;
    }
}

__global__ void __launch_bounds__(64) attn_naive(const float* qkv, float* o) {
    const int bh = blockIdx.y, b = bh / NH, hh = bh % NH;
    const int t = blockIdx.x * 64 + threadIdx.x;
    const float* qp = qkv + (long)(b * SEQ + t) * (3 * D) + hh * HD;
    float q[64], acc[64];
#pragma unroll
    for (int d = 0; d < 64; ++d) { q[d] = qp[d] * 0.125f; acc[d] = 0.f; }
    float la = 0.f;
    const int smax = blockIdx.x * 64 + 63;
    for (int s = smax - 1; s >= 0; --s) {
        const float* kp = qkv + (long)(b * SEQ + s) * (3 * D) + D + hh * HD;
        const float* vp = kp + D;
        float z = 0.f;
#pragma unroll
        for (int d = 0; d < 64; ++d) z = fmaf(q[d], kp[d], z);
        if (s < t) {
            const float sp = fmaxf(z, 0.f) + log1pf(expf(-fabsf(z)));
            const float w = expf(z - sp + la);
#pragma unroll
            for (int d = 0; d < 64; ++d) acc[d] = fmaf(w, vp[d], acc[d]);
            la -= sp;
        }
    }
    float* op = o + (long)(b * SEQ + t) * D + hh * HD;
#pragma unroll
    for (int d = 0; d < 64; ++d) op[d] = acc[d];
}
}

using namespace nv;

static void gemm(hipStream_t st, GArgs g, int Mmax, int batch) {
    dim3 grid(g.N / 64, (Mmax + 63) / 64, batch);
    hipLaunchKernelGGL(gemm_naive, grid, dim3(256), 0, st, g);
}
static GArgs G0(const float* A, int lda, const float* B, int ldb, float* C, int ldc, int M, int N, int K) {
    GArgs g{}; g.A = A; g.lda = lda; g.B = B; g.ldb = ldb; g.C = C; g.ldc = ldc; g.M = M; g.N = N; g.K = K; return g;
}

extern "C" void kernel_launch(void* const* d_in, const int* in_sizes, int n_in, void* d_out, int out_size, void* d_ws, size_t ws_size, hipStream_t stream) {
    const size_t MiB = 1u << 20;
    if (n_in != 28 || ws_size < 260 * MiB) { fprintf(stderr, "kernel_launch: unexpected n_in %d / ws %zu\n", n_in, ws_size); return; }
    const float* x = (const float*)d_in[0]; const float* p = (const float*)d_in[1];
    const float* ab_w_in = (const float*)d_in[2];
    const float *lam_re = (const float*)d_in[3], *lam_im = (const float*)d_in[4], *log_dt = (const float*)d_in[5], *b_re = (const float*)d_in[6], *b_im = (const float*)d_in[7];
    const float *c_re = (const float*)d_in[8], *c_im = (const float*)d_in[9], *s5d = (const float*)d_in[10], *w_glu = (const float*)d_in[11];
    const float *pool_w = (const float*)d_in[12], *pool_scale = (const float*)d_in[13], *ab_w_out = (const float*)d_in[14];
    const float *w_qkv = (const float*)d_in[15], *w_so = (const float*)d_in[16];
    const float *ln_mix_g = (const float*)d_in[17], *ln_mix_b = (const float*)d_in[18], *ln_ffn_g = (const float*)d_in[19], *ln_ffn_b = (const float*)d_in[20];
    const float *router_w = (const float*)d_in[21], *router_b = (const float*)d_in[22];
    const float *w1 = (const float*)d_in[23], *w3 = (const float*)d_in[24], *w2 = (const float*)d_in[25], *wp = (const float*)d_in[26], *wg = (const float*)d_in[27];
    char* ws = (char*)d_ws;
    float* R0 = (float*)(ws); float* R1 = (float*)(ws + 64 * MiB); float* R2 = (float*)(ws + 128 * MiB); float* R3 = (float*)(ws + 192 * MiB);
    int* cnt = (int*)(ws + 256 * MiB); int* lists = (int*)(ws + 256 * MiB + 4096); float* entw = (float*)(ws + 256 * MiB + 4096 + (size_t)NE * CAP * 4);
    float* out = (float*)d_out;

    auto ffn_block = [&](int layer, const float* x1, float* pple, float* gh, float* ffn, float* xout) {
        gemm(stream, G0(p + (size_t)layer * T * PLE, PLE, wp + (size_t)layer * PLE * D, D, pple, D, T, D, PLE), T, 1);
        { GArgs g = G0(x1, D, wg + (size_t)layer * D * D, D, pple, D, T, D, D); g.epi = 1; g.aux = pple; g.ldaux = D; gemm(stream, g, T, 1); }
        hipMemsetAsync(cnt, 0, 64, stream);
        hipLaunchKernelGGL(route_naive, dim3(T / 4), dim3(256), 0, stream, x1, router_w, router_b, cnt, lists, entw);
        { GArgs g = G0(x1, D, w1 + (size_t)layer * NE * D * DEXP, DEXP, gh, DEXP, 0, DEXP, D); g.Mptr = cnt; g.amap = lists; g.ashift = 1; g.cmap = lists; g.cshift = 0; g.sMap = CAP; g.sB = (long)D * DEXP; gemm(stream, g, T, NE); }
        { GArgs g = G0(x1, D, w3 + (size_t)layer * NE * D * DEXP, DEXP, gh, DEXP, 0, DEXP, D); g.Mptr = cnt; g.amap = lists; g.ashift = 1; g.cmap = lists; g.cshift = 0; g.sMap = CAP; g.sB = (long)D * DEXP;
          g.epi = 4; g.aux = gh; g.ldaux = DEXP; g.rs = entw; gemm(stream, g, T, NE); }
        hipMemsetAsync(ffn, 0, (size_t)T * D * 4, stream);
        { GArgs g = G0(gh, DEXP, w2 + (size_t)layer * NE * DEXP * D, D, ffn, D, 0, D, DEXP); g.Mptr = cnt; g.amap = lists; g.ashift = 0; g.cmap = lists; g.cshift = 1; g.sMap = CAP; g.sB = (long)DEXP * D; g.epi = 5; gemm(stream, g, T, NE); }
        hipLaunchKernelGGL(ln_naive, dim3(T / 4), dim3(256), 0, stream, x1, (const float*)ffn, (const float*)pple, ln_ffn_g + layer * D, ln_ffn_b + layer * D, xout);
    };

    gemm(stream, G0(x, D, ab_w_in, D, R0, D, T, D, D), T, 1);
    hipLaunchKernelGGL(s5_naive, dim3(BATCH * S5G), dim3(64), 0, stream, (const float*)R0, lam_re, lam_im, log_dt, b_re, b_im, c_re, c_im, s5d, R1);
    float* pooled = R1 + (size_t)T * DA;
    hipLaunchKernelGGL(pool_naive, dim3((T * DB + 255) / 256), dim3(256), 0, stream, (const float*)R0, pooled);
    { GArgs g = G0(R1, DA, w_glu, DA, R2, D, T, DA, DA); g.epi = 1; g.aux = R1; g.ldaux = DA; gemm(stream, g, T, 1); }
    { GArgs g = G0(pooled, DB, pool_w, PC, R2 + DA, D, T, PC, PC); g.sA = PC; g.sB = (long)PC * PC; g.sC = PC; g.epi = 2; g.vec = pool_scale; g.sVec = PC; gemm(stream, g, T, PG); }
    gemm(stream, G0(R2, D, ab_w_out, D, R0, D, T, D, D), T, 1);
    hipLaunchKernelGGL(ln_naive, dim3(T / 4), dim3(256), 0, stream, x, (const float*)R0, (const float*)nullptr, ln_mix_g, ln_mix_b, R3);
    ffn_block(0, R3, R0, R1, R2, out);
    gemm(stream, G0(out, D, w_qkv, 3 * D, R0, 3 * D, T, 3 * D, D), T, 1);
    hipLaunchKernelGGL(attn_naive, dim3(SEQ / 64, BATCH * NH), dim3(64), 0, stream, (const float*)R0, R3);
    gemm(stream, G0(R3, D, w_so, D, R0, D, T, D, D), T, 1);
    hipLaunchKernelGGL(ln_naive, dim3(T / 4), dim3(256), 0, stream, (const float*)out, (const float*)R0, (const float*)nullptr, ln_mix_g + D, ln_mix_b + D, R1);
    ffn_block(1, R1, R0, R2, R3, out);
}
```
